# Optimizing an MI355X kernel written in HIP

```python
import jax, jax.numpy as jnp
from jax import lax
import numpy as np

D_MODEL = 1024
BATCH = 8
SEQ = 2048
DEPTH = 1

GRID_W = 64
CTX_LEN = 256
D_RNN = 1024
N_LRU_BLOCKS = 16
LRU_BLOCK = D_RNN // N_LRU_BLOCKS
LRU_C = 8.0
CONV_W = 4
CONV_PAD_LEFT = 2
N_HEADS = 16
HEAD_DIM = 64
D_ATT = N_HEADS * HEAD_DIM
WIN_ROWS = 8
WIN_COLS = 16
Q_BLOCK_COLS = 16
K_BLOCK_COLS = Q_BLOCK_COLS + WIN_COLS
D_FF = 4 * D_MODEL
N_MOD = 6
EPS = 1e-6
NEG = -1e30
D_IN = 2 * D_RNN + 3 * D_ATT + 2 * D_MODEL
SPLITS = (D_RNN, 2 * D_RNN, 2 * D_RNN + D_ATT, 2 * D_RNN + 2 * D_ATT, 2 * D_RNN + 3 * D_ATT)

kernel_name = 'hybrid_rglru_natten_dit_block'


def rms_norm(x, g):
    xf = x.astype(jnp.float32)
    y = xf * lax.rsqrt(jnp.mean(xf * xf, axis=-1, keepdims=True) + EPS)
    return (y * g.astype(jnp.float32)).astype(x.dtype)


def modulate(x, g, shift, scale):
    return rms_norm(x, g) * (1.0 + scale) + shift


def short_conv(x, w, b):
    L = x.shape[1]
    xp = jnp.pad(x, ((0, 0), (CONV_PAD_LEFT, CONV_W - 1 - CONV_PAD_LEFT), (0, 0)))
    out = b
    for k in range(CONV_W):
        out = out + w[k] * xp[:, k:k + L]
    return out


def rglru_coeffs(xc, w_rg, b_rg, lam):
    Bn, L, _ = xc.shape
    xb = xc.reshape(Bn, L, N_LRU_BLOCKS, LRU_BLOCK)
    gates = jnp.einsum('blhi,ghij->gblhj', xb, w_rg).reshape(2, Bn, L, D_RNN)
    gates = jax.nn.sigmoid(gates + b_rg[:, None, None, :])
    r, i = gates[0], gates[1]
    log_a = -LRU_C * r * jax.nn.softplus(-lam)
    a = jnp.exp(log_a)
    b = jnp.sqrt(-jnp.expm1(2.0 * log_a)) * (i * xc)
    return a, b


def _lin_combine(e, l):
    a1, b1 = e
    a2, b2 = l
    return a1 * a2, a2 * b1 + b2


def linear_scan(a, b, h0, reverse):
    idx = -1 if reverse else 0
    b = b.at[:, idx].add(a[:, idx] * h0)
    _, h = lax.associative_scan(_lin_combine, (a, b), axis=1, reverse=reverse)
    return h


def rglru_branch(xr, xr_c, conv_w, conv_b, w_rg, b_rg, lam):
    xc = short_conv(xr, conv_w, conv_b)
    xc_c = short_conv(xr_c, conv_w, conv_b)
    h_lat = jnp.zeros_like(xc)
    h_ctx = jnp.zeros_like(xc_c)
    for d, rev in enumerate((False, True)):
        a_c, b_c = rglru_coeffs(xc_c, w_rg[d], b_rg[d], lam[d])
        hc = linear_scan(a_c, b_c, jnp.zeros_like(b_c[:, 0]), rev)
        h_final = hc[:, 0] if rev else hc[:, -1]
        a_l, b_l = rglru_coeffs(xc, w_rg[d], b_rg[d], lam[d])
        h_lat = h_lat + linear_scan(a_l, b_l, h_final, rev)
        h_ctx = h_ctx + hc
    return h_lat, h_ctx


def na_attention(q, k, v, k_c, v_c, rpb):
    Bn, S = q.shape[0], q.shape[1]
    rows = S // GRID_W
    wr = min(WIN_ROWS, rows)
    n_cb = GRID_W // Q_BLOCK_COLS
    scale = HEAD_DIM ** -0.5
    qg = (q * scale).reshape(Bn, rows, GRID_W, N_HEADS, HEAD_DIM)
    kg = k.reshape(Bn, rows, GRID_W, N_HEADS, HEAD_DIM)
    vg = v.reshape(Bn, rows, GRID_W, N_HEADS, HEAD_DIM)
    q_col = np.arange(GRID_W).reshape(n_cb, Q_BLOCK_COLS)
    col_start = np.clip(q_col - WIN_COLS // 2, 0, GRID_W - WIN_COLS)
    band_start = np.clip(np.arange(n_cb) * Q_BLOCK_COLS - WIN_COLS // 2, 0, GRID_W - K_BLOCK_COLS)
    k_col = band_start[:, None] + np.arange(K_BLOCK_COLS)
    dc = k_col[:, None, :] - q_col[:, :, None]
    col_ok = (k_col[:, None, :] >= col_start[:, :, None]) & (k_col[:, None, :] < col_start[:, :, None] + WIN_COLS)
    col_bias = rpb.astype(jnp.float32)[:, :, np.clip(dc + WIN_COLS - 1, 0, 2 * WIN_COLS - 2)]
    col_bias = jnp.where(col_ok[None, None], col_bias, NEG).transpose(0, 2, 3, 1, 4)

    def row_block(r):
        q_r = lax.dynamic_index_in_dim(qg, r, axis=1, keepdims=False).reshape(Bn, n_cb, Q_BLOCK_COLS, N_HEADS, HEAD_DIM)
        r0 = jnp.clip(r - wr // 2, 0, rows - wr)
        k_blk = lax.dynamic_slice_in_dim(kg, r0, wr, axis=1)[:, :, k_col]
        v_blk = lax.dynamic_slice_in_dim(vg, r0, wr, axis=1)[:, :, k_col]
        dr = r0 + jnp.arange(wr) - r + (WIN_ROWS - 1)
        bias = jnp.take(col_bias, dr, axis=3)
        s_loc = jnp.einsum('bjqhd,bwjkhd->bhjqwk', q_r, k_blk, preferred_element_type=jnp.float32) + bias[None]
        s_loc = s_loc.reshape(Bn, N_HEADS, n_cb, Q_BLOCK_COLS, wr * K_BLOCK_COLS)
        s_ctx = jnp.einsum('bjqhd,bchd->bhjqc', q_r, k_c, preferred_element_type=jnp.float32)
        p = jax.nn.softmax(jnp.concatenate([s_loc, s_ctx], axis=-1), axis=-1)
        p_loc = p[..., :wr * K_BLOCK_COLS].reshape(Bn, N_HEADS, n_cb, Q_BLOCK_COLS, wr, K_BLOCK_COLS).astype(v.dtype)
        p_ctx = p[..., wr * K_BLOCK_COLS:].astype(v.dtype)
        o = jnp.einsum('bhjqwk,bwjkhd->bjqhd', p_loc, v_blk) + jnp.einsum('bhjqc,bchd->bjqhd', p_ctx, v_c)
        return o.reshape(Bn, GRID_W, D_ATT)

    out = lax.map(row_block, jnp.arange(rows))
    return out.transpose(1, 0, 2, 3).reshape(Bn, S, D_ATT)


def ctx_attention(q_c, k_c, v_c):
    s = jnp.einsum('bqhd,bkhd->bhqk', q_c * HEAD_DIM ** -0.5, k_c, preferred_element_type=jnp.float32)
    p = jax.nn.softmax(s, axis=-1).astype(v_c.dtype)
    o = jnp.einsum('bhqk,bkhd->bqhd', p, v_c)
    return o.reshape(o.shape[0], o.shape[1], D_ATT)


def heads(t):
    return t.reshape(t.shape[0], t.shape[1], N_HEADS, HEAD_DIM)


def token_mixer(u, u_c, w_in, b_gate, conv_w, conv_b, w_rg, b_rg, lam, rpb, w_lru_out, w_na_out, w_o, ctx_out):
    xr, gr, q, k, v, gl = jnp.split(u @ w_in, SPLITS, axis=-1)
    xr_c, gr_c, q_c, k_c, v_c, gl_c = jnp.split(u_c @ w_in, SPLITS, axis=-1)
    h_lat, h_ctx = rglru_branch(xr, xr_c, conv_w, conv_b, w_rg, b_rg, lam)
    y_lru = (h_lat * jax.nn.gelu(gr)) @ w_lru_out
    y_na = na_attention(heads(q), heads(k), heads(v), heads(k_c), heads(v_c), rpb) @ w_na_out
    g_lru, g_na = jnp.split(jax.nn.sigmoid(gl + b_gate), 2, axis=-1)
    y = (g_lru * y_lru + g_na * y_na) @ w_o
    if not ctx_out:
        return y, None
    y_lru_c = (h_ctx * jax.nn.gelu(gr_c)) @ w_lru_out
    y_na_c = ctx_attention(heads(q_c), heads(k_c), heads(v_c)) @ w_na_out
    gc_lru, gc_na = jnp.split(jax.nn.sigmoid(gl_c + b_gate), 2, axis=-1)
    y_c = (gc_lru * y_lru_c + gc_na * y_na_c) @ w_o
    return y, y_c


def squared_relu_mlp(u, w1, w2):
    return jnp.square(jax.nn.relu(u @ w1)) @ w2


def setup_inputs(seed: int = 0) -> dict:
    key = jax.random.key(seed)
    ks = jax.random.split(key, 24)
    f32 = jnp.float32

    def nrm(k, shape, fan_in, gain=1.0):
        return gain * jax.random.normal(k, shape, f32) * fan_in ** -0.5

    u = jax.random.uniform(ks[13], (DEPTH, 2, D_RNN), f32, 0.9, 0.999)
    s = u ** (1.0 / LRU_C)
    lam = jnp.log(s) - jnp.log1p(-s)
    return {
        'x': jax.random.normal(ks[0], (BATCH, SEQ, D_MODEL), f32),
        'c': jax.random.normal(ks[1], (BATCH, D_MODEL), f32),
        'ctx': jax.random.normal(ks[2], (BATCH, CTX_LEN, D_MODEL), f32),
        'c_ctx': jax.random.normal(ks[3], (D_MODEL,), f32),
        'w_ada': nrm(ks[4], (DEPTH, D_MODEL, N_MOD * D_MODEL), D_MODEL, 0.5),
        'b_ada': 0.02 * jax.random.normal(ks[5], (DEPTH, N_MOD * D_MODEL), f32),
        'g_norm': 1.0 + 0.05 * jax.random.normal(ks[6], (DEPTH, 4, D_MODEL), f32),
        'w_in': nrm(ks[7], (DEPTH, D_MODEL, D_IN), D_MODEL),
        'b_gate': 0.02 * jax.random.normal(ks[8], (DEPTH, 2 * D_MODEL), f32),
        'conv_w': nrm(ks[9], (DEPTH, CONV_W, D_RNN), CONV_W),
        'conv_b': 0.02 * jax.random.normal(ks[10], (DEPTH, D_RNN), f32),
        'w_rg': nrm(ks[11], (DEPTH, 2, 2, N_LRU_BLOCKS, LRU_BLOCK, LRU_BLOCK), LRU_BLOCK),
        'b_rg': 0.02 * jax.random.normal(ks[12], (DEPTH, 2, 2, D_RNN), f32),
        'lam': lam,
        'rpb': 0.1 * jax.random.normal(ks[14], (DEPTH, N_HEADS, 2 * WIN_ROWS - 1, 2 * WIN_COLS - 1), f32),
        'w_lru_out': nrm(ks[15], (DEPTH, D_RNN, D_MODEL), D_RNN),
        'w_na_out': nrm(ks[16], (DEPTH, D_ATT, D_MODEL), D_ATT),
        'w_o': nrm(ks[17], (DEPTH, D_MODEL, D_MODEL), D_MODEL),
        'w_mlp1': nrm(ks[18], (DEPTH, D_MODEL, D_FF), D_MODEL),
        'w_mlp2': nrm(ks[19], (DEPTH, D_FF, D_MODEL), D_FF),
    }


def reference(x, c, ctx, c_ctx, w_ada, b_ada, g_norm, w_in, b_gate, conv_w, conv_b, w_rg, b_rg, lam, rpb,
              w_lru_out, w_na_out, w_o, w_mlp1, w_mlp2):
    for l in range(DEPTH):
        update_ctx = l < DEPTH - 1
        mod = jax.nn.silu(c) @ w_ada[l] + b_ada[l]
        sh1, sc1, gt1, sh2, sc2, gt2 = [m[:, None, :] for m in jnp.split(mod, N_MOD, axis=-1)]
        mod_c = jax.nn.silu(c_ctx) @ w_ada[l] + b_ada[l]
        sh1c, sc1c, gt1c, sh2c, sc2c, gt2c = jnp.split(mod_c, N_MOD, axis=-1)
        u = modulate(x, g_norm[l, 0], sh1, sc1)
        u_c = modulate(ctx, g_norm[l, 0], sh1c, sc1c)
        y, y_c = token_mixer(u, u_c, w_in[l], b_gate[l], conv_w[l], conv_b[l], w_rg[l], b_rg[l], lam[l], rpb[l],
                             w_lru_out[l], w_na_out[l], w_o[l], update_ctx)
        x = x + gt1 * rms_norm(y, g_norm[l, 1])
        u = modulate(x, g_norm[l, 2], sh2, sc2)
        x = x + gt2 * rms_norm(squared_relu_mlp(u, w_mlp1[l], w_mlp2[l]), g_norm[l, 3])
        if update_ctx:
            ctx = ctx + gt1c * rms_norm(y_c, g_norm[l, 1])
            u_c = modulate(ctx, g_norm[l, 2], sh2c, sc2c)
            ctx = ctx + gt2c * rms_norm(squared_relu_mlp(u_c, w_mlp1[l], w_mlp2[l]), g_norm[l, 3])
    return x
```

```cpp
#include <hip/hip_runtime.h>
#include <cstdio>
#include <cstdint>

constexpr int D = 1024, BATCH = 8, SEQ = 2048, CTX = 256, NH = 16, HD = 64, FF = 4096, DIN = 7168;
constexpr int ML = BATCH * SEQ;
constexpr int MC = BATCH * CTX;
constexpr int MT = ML + MC;
constexpr int NMOD = 6 * D;
constexpr float EPS = 1e-6f;
constexpr float LOG2E = 1.4426950408889634f;
constexpr float C2 = 0.125f * LOG2E;

constexpr size_t MiB = 1u << 20;
constexpr size_t WS_CTL = 0, CTL_ZERO_BYTES = 1 * MiB;
constexpr size_t WS_MOD = 1 * MiB;
constexpr size_t WS_XCH = 1 * MiB + 512 * 1024;
constexpr size_t WS_WIN = 4 * MiB;
constexpr size_t WS_WLN = 18 * MiB;
constexpr size_t WS_WO = 22 * MiB;
constexpr size_t WS_W1 = 24 * MiB;
constexpr size_t WS_W2 = 32 * MiB;
constexpr size_t WS_WRG = 40 * MiB;
constexpr size_t WS_U = 42 * MiB;
constexpr size_t WS_XR = 78 * MiB;
constexpr size_t WS_HG = 114 * MiB;
constexpr size_t WS_AO = 146 * MiB;
constexpr size_t WS_K = 178 * MiB;
constexpr size_t WS_V = 214 * MiB;
constexpr size_t WS_HMID = 114 * MiB;
constexpr size_t WS_END = 250 * MiB;

typedef unsigned short bf16;
typedef float f32x4 __attribute__((ext_vector_type(4)));
typedef unsigned u32x4 __attribute__((ext_vector_type(4)));
typedef unsigned u32x2 __attribute__((ext_vector_type(2)));

__device__ __forceinline__ unsigned f2bf(float f) { unsigned u = __builtin_bit_cast(unsigned, f); return (u + 0x7fffu + ((u >> 16) & 1u)) >> 16; }
__device__ __forceinline__ unsigned pk2(float lo, float hi) { return f2bf(lo) | (f2bf(hi) << 16); }
__device__ __forceinline__ float bf2f(unsigned short b) { return __builtin_bit_cast(float, (unsigned)b << 16); }
__device__ __forceinline__ float bfround(float f) { return bf2f((unsigned short)f2bf(f)); }
__device__ __forceinline__ float sigmoid_f(float x) { return __builtin_amdgcn_rcpf(1.0f + __builtin_amdgcn_exp2f(-LOG2E * x)); }
__device__ __forceinline__ float gelu_tanh(float x) { const float u = x + 0.044715f * x * x * x; return x * __builtin_amdgcn_rcpf(1.0f + __builtin_amdgcn_exp2f(-2.302208198f * u)); }
__device__ __forceinline__ float wave_sum(float v) {
#pragma unroll
    for (int o = 1; o < 64; o <<= 1) v += __shfl_xor(v, o);
    return v;
}

struct Ptrs {
    const float *x, *c, *ctx, *c_ctx, *w_ada, *b_ada, *g_norm, *w_in, *b_gate, *conv_w, *conv_b, *w_rg, *b_rg, *lam, *rpb, *w_lru_out, *w_na_out, *w_o, *w_mlp1, *w_mlp2;
    float* out; unsigned char* ws;
};

__device__ __forceinline__ void transpose_item(const float* W, int K, int N, bf16* WT, int row_off, float* scr, int item, int lane) {
    const int nblk = N / 32, kb = item / nblk, nb = item % nblk, k0 = 64 * kb, n0 = 32 * nb;
#pragma unroll 8
    for (int i = 0; i < 32; ++i) { const int kk = 2 * i + (lane >> 5); scr[kk * 33 + (lane & 31)] = W[(size_t)(k0 + kk) * N + n0 + (lane & 31)]; }
    __builtin_amdgcn_wave_barrier(); asm volatile("s_waitcnt lgkmcnt(0)" ::: "memory");
    const int c = lane & 7;
#pragma unroll
    for (int j = 0; j < 4; ++j) { const int n = (lane >> 3) + 8 * j; const float* s = scr + (8 * c) * 33 + n;
        u32x4 o; o.x = pk2(s[0 * 33], s[1 * 33]); o.y = pk2(s[2 * 33], s[3 * 33]); o.z = pk2(s[4 * 33], s[5 * 33]); o.w = pk2(s[6 * 33], s[7 * 33]);
        *(u32x4*)(WT + (size_t)(row_off + n0 + n) * K + k0 + 8 * c) = o; }
    asm volatile("s_waitcnt lgkmcnt(0)" ::: "memory"); __builtin_amdgcn_wave_barrier();
}

__device__ __forceinline__ void p0_prologue(const Ptrs& P, unsigned char* lds, int vb, int nb) {
    const int tid = threadIdx.x, lane = tid & 63, wave = tid >> 6;
    const int gw = vb * 8 + wave, ngw = nb * 8;
    float* scr = (float*)(lds + wave * 16384);
    bf16* Win = (bf16*)(P.ws + WS_WIN); bf16* Wln = (bf16*)(P.ws + WS_WLN); bf16* Wo = (bf16*)(P.ws + WS_WO); bf16* W1 = (bf16*)(P.ws + WS_W1); bf16* W2 = (bf16*)(P.ws + WS_W2);
    bf16* Wrg = (bf16*)(P.ws + WS_WRG);
    constexpr int I_IN = (D / 64) * (DIN / 32), I_SQ = (D / 64) * (D / 32), I_1 = (D / 64) * (FF / 32), I_2 = (FF / 64) * (D / 32), I_RG = 64 * 2;
    constexpr int NITEMS = I_IN + 3 * I_SQ + I_1 + I_2 + I_RG;
    for (int it = gw; it < NITEMS; it += ngw) {
        int r = it;
        if (r < I_IN) { transpose_item(P.w_in, D, DIN, Win, 0, scr, r, lane); continue; } r -= I_IN;
        if (r < I_SQ) { transpose_item(P.w_lru_out, D, D, Wln, 0, scr, r, lane); continue; } r -= I_SQ;
        if (r < I_SQ) { transpose_item(P.w_na_out, D, D, Wln, D, scr, r, lane); continue; } r -= I_SQ;
        if (r < I_SQ) { transpose_item(P.w_o, D, D, Wo, 0, scr, r, lane); continue; } r -= I_SQ;
        if (r < I_1) { transpose_item(P.w_mlp1, D, FF, W1, 0, scr, r, lane); continue; } r -= I_1;
        if (r < I_2) { transpose_item(P.w_mlp2, FF, D, W2, 0, scr, r, lane); continue; } r -= I_2;
        { const int mat = r >> 1, half = r & 1; transpose_item(P.w_rg + (size_t)mat * 4096, 64, 64, Wrg + (size_t)mat * 4096, 0, scr, half, lane); }
    }
    __syncthreads();
    float* mod = (float*)(P.ws + WS_MOD);
    for (int grp = vb; grp < NMOD / 64; grp += nb) {
        float* s = (float*)lds;
        float* red = (float*)(lds + 40960);
        for (int i = tid; i < 9 * D; i += 512) { const int r = i >> 10, k = i & 1023; const float v = (r < 8) ? P.c[r * D + k] : P.c_ctx[k]; s[i] = v * sigmoid_f(v); }
        __syncthreads();
        float acc[9];
#pragma unroll
        for (int r = 0; r < 9; ++r) acc[r] = 0.f;
        const int n = grp * 64 + lane;
#pragma unroll 4
        for (int k = wave * 128; k < wave * 128 + 128; ++k) { const float w = P.w_ada[(size_t)k * NMOD + n];
#pragma unroll
            for (int r = 0; r < 9; ++r) acc[r] += s[r * D + k] * w; }
#pragma unroll
        for (int r = 0; r < 9; ++r) red[(wave * 9 + r) * 64 + lane] = acc[r];
        __syncthreads();
        for (int i = tid; i < 9 * 64; i += 512) { const int r = i >> 6, cc = i & 63; float t = 0.f;
#pragma unroll
            for (int w = 0; w < 8; ++w) t += red[(w * 9 + r) * 64 + cc];
            mod[r * NMOD + grp * 64 + cc] = t + P.b_ada[grp * 64 + cc]; }
        __syncthreads();
    }
}

__device__ __forceinline__ void p1_modulate(const Ptrs& P, int vb, int nb) {
    const int tid = threadIdx.x, lane = tid & 63, wave = tid >> 6;
    const int gw = vb * 8 + wave, ngw = nb * 8;
    const float* mod = (const float*)(P.ws + WS_MOD); bf16* U = (bf16*)(P.ws + WS_U);
    for (int m = gw; m < MT; m += ngw) {
        const float* xrow = (m < ML) ? P.x + (size_t)m * D : P.ctx + (size_t)(m - ML) * D;
        const int r = (m < ML) ? (m >> 11) : 8;
        const f32x4* xr = (const f32x4*)xrow + lane;
        f32x4 v[4]; float ss = 0.f;
#pragma unroll
        for (int j = 0; j < 4; ++j) { v[j] = xr[64 * j]; ss += (v[j].x * v[j].x + v[j].y * v[j].y) + (v[j].z * v[j].z + v[j].w * v[j].w); }
        const float rstd = 1.0f / sqrtf(wave_sum(ss) * (1.0f / D) + EPS);
        unsigned long long* o8 = (unsigned long long*)(U + (size_t)m * D) + lane;
#pragma unroll
        for (int j = 0; j < 4; ++j) { const int col = 4 * lane + 256 * j;
            const f32x4 g = *(const f32x4*)(P.g_norm + col), sh = *(const f32x4*)(mod + r * NMOD + col), sc = *(const f32x4*)(mod + r * NMOD + D + col);
            const f32x4 o = (v[j] * rstd) * g * (sc + 1.0f) + sh;
            o8[64 * j] = (unsigned long long)pk2(o.x, o.y) | ((unsigned long long)pk2(o.z, o.w) << 32); }
    }
}

struct Args { Ptrs p; int ph_lo, ph_hi; };
__global__ void __launch_bounds__(512, 2) fwd_kernel(Args a) {
    extern __shared__ __attribute__((aligned(16))) unsigned char lds[];
    const int nb = gridDim.x, bx = blockIdx.x, vb = (nb % 8 == 0) ? (bx % 8) * (nb / 8) + bx / 8 : bx;
    if (a.ph_lo <= 0 && 0 < a.ph_hi) p0_prologue(a.p, lds, vb, nb);
    if (a.ph_lo <= 1 && 1 < a.ph_hi) p1_modulate(a.p, vb, nb);
}

template <class E>
__global__ void __launch_bounds__(256) naive_gemm(const bf16* A, const bf16* Bt, int M, int N, int K, E e) {
    __shared__ float As[32][65];
    __shared__ float Bs[32][65];
    const int tid = threadIdx.x, ty = tid >> 4, tx = tid & 15, bm = blockIdx.y * 64, bn = blockIdx.x * 64;
    const int lr = tid >> 2, lk = (tid & 3) * 8;
    float acc[4][4];
#pragma unroll
    for (int i = 0; i < 4; ++i)
#pragma unroll
        for (int j = 0; j < 4; ++j) acc[i][j] = 0.f;
    for (int k0 = 0; k0 < K; k0 += 32) {
        const u32x4 av = *(const u32x4*)(A + (size_t)(bm + lr) * K + k0 + lk), bv = *(const u32x4*)(Bt + (size_t)(bn + lr) * K + k0 + lk);
#pragma unroll
        for (int j = 0; j < 4; ++j) {
            As[lk + 2 * j][lr] = __builtin_bit_cast(float, av[j] << 16); As[lk + 2 * j + 1][lr] = __builtin_bit_cast(float, av[j] & 0xffff0000u);
            Bs[lk + 2 * j][lr] = __builtin_bit_cast(float, bv[j] << 16); Bs[lk + 2 * j + 1][lr] = __builtin_bit_cast(float, bv[j] & 0xffff0000u); }
        __syncthreads();
#pragma unroll 8
        for (int k = 0; k < 32; ++k) { float a[4], b[4];
#pragma unroll
            for (int i = 0; i < 4; ++i) { a[i] = As[k][ty * 4 + i]; b[i] = Bs[k][tx + 16 * i]; }
#pragma unroll
            for (int i = 0; i < 4; ++i)
#pragma unroll
                for (int j = 0; j < 4; ++j) acc[i][j] += a[i] * b[j]; }
        __syncthreads();
    }
#pragma unroll
    for (int i = 0; i < 4; ++i)
#pragma unroll
        for (int j = 0; j < 4; ++j) e(bm + ty * 4 + i, bn + tx + 16 * j, acc[i][j]);
}

struct E1 {
    bf16 *XR, *GG, *Q, *K, *V, *GATE; const float* b_gate;
    __device__ __forceinline__ void operator()(int row, int col, float v) const {
        const bool lat = row < ML;
        if (col < 1024) XR[(size_t)row * D + col] = (bf16)f2bf(v);
        else if (col < 2048) { if (lat) GG[(size_t)row * D + col - 1024] = (bf16)f2bf(gelu_tanh(v)); }
        else if (col < 3072) { if (lat) Q[(size_t)row * D + col - 2048] = (bf16)f2bf(v * C2); }
        else if (col < 4096) K[(size_t)row * D + col - 3072] = (bf16)f2bf(v);
        else if (col < 5120) V[(size_t)row * D + col - 4096] = (bf16)f2bf(v);
        else if (lat) GATE[(size_t)row * 2048 + col - 5120] = (bf16)f2bf(sigmoid_f(v + b_gate[col - 5120]));
    }
};
struct E2a { float* Y; __device__ __forceinline__ void operator()(int row, int col, float v) const { Y[(size_t)row * D + col] = v; } };
struct E2b { const float* Y; const bf16* GATE; bf16* Z;
    __device__ __forceinline__ void operator()(int row, int col, float v) const {
        const float gl = bf2f(GATE[(size_t)row * 2048 + col]), gn = bf2f(GATE[(size_t)row * 2048 + 1024 + col]);
        Z[(size_t)row * D + col] = (bf16)f2bf(gl * Y[(size_t)row * D + col] + gn * v); } };
struct E4 { bf16* H; __device__ __forceinline__ void operator()(int row, int col, float v) const { const float r = v > 0.f ? v : 0.f; H[(size_t)row * FF + col] = (bf16)f2bf(r * r); } };

__global__ void __launch_bounds__(64) naive_attn(const bf16* Q, const bf16* K, const bf16* V, bf16* O, const float* rpb) {
    const int gid = blockIdx.x * 64 + threadIdx.x;
    const int t = gid & 2047, h = (gid >> 11) & 15, b = gid >> 15;
    const int r = t >> 6, qc = t & 63;
    int r0 = r - 4; r0 = r0 < 0 ? 0 : (r0 > 24 ? 24 : r0);
    int cs = qc - 8; cs = cs < 0 ? 0 : (cs > 48 ? 48 : cs);
    float q[64], o[64];
    const bf16* qp = Q + (size_t)(b * SEQ + t) * D + h * HD;
#pragma unroll
    for (int d = 0; d < 64; ++d) { q[d] = bf2f(qp[d]); o[d] = 0.f; }
    float m = -1e30f, l = 0.f;
    for (int kk = 0; kk < 128 + CTX; ++kk) {
        size_t row; float bias = 0.f;
        if (kk < 128) { const int kr = r0 + (kk >> 4), kc = cs + (kk & 15); row = (size_t)b * SEQ + kr * 64 + kc; bias = rpb[(h * 15 + (kr - r + 7)) * 31 + (kc - qc + 15)] * LOG2E; }
        else row = (size_t)ML + b * CTX + (kk - 128);
        const bf16* kp = K + row * D + h * HD; const bf16* vp = V + row * D + h * HD;
        float s = bias;
#pragma unroll
        for (int d = 0; d < 64; ++d) s += q[d] * bf2f(kp[d]);
        const float mn = fmaxf(m, s), sc = __builtin_amdgcn_exp2f(m - mn), p = __builtin_amdgcn_exp2f(s - mn);
        l = l * sc + p; m = mn;
#pragma unroll
        for (int d = 0; d < 64; ++d) o[d] = o[d] * sc + p * bf2f(vp[d]);
    }
    const float il = 1.0f / l;
    bf16* op = O + (size_t)(b * SEQ + t) * D + h * HD;
#pragma unroll
    for (int d = 0; d < 64; ++d) op[d] = (bf16)f2bf(o[d] * il);
}

__global__ void __launch_bounds__(64) naive_lru(const bf16* XR, const bf16* Wrg, bf16* PART, bf16* HG, const float* conv_w, const float* conv_b, const float* b_rg, const float* lam) {
    __shared__ float w[2][64][65];
    __shared__ float xcs[64];
    const int c = threadIdx.x, j = blockIdx.x & 15, b = blockIdx.x >> 4, ch = j * 64 + c;
    const float cw0 = conv_w[ch], cw1 = conv_w[D + ch], cw2 = conv_w[2 * D + ch], cw3 = conv_w[3 * D + ch], cb = conv_b[ch];
    for (int d = 0; d < 2; ++d) {
        __syncthreads();
        for (int g = 0; g < 2; ++g)
            for (int i = 0; i < 64; ++i) w[g][i][c] = bf2f(Wrg[((size_t)((d * 2 + g) * 16 + j) * 64 + c) * 64 + i]);
        __syncthreads();
        const float br = b_rg[(d * 2 + 0) * D + ch], bi = b_rg[(d * 2 + 1) * D + ch];
        const float lm = lam[d * D + ch];
        const float sp8 = 8.0f * log1pf(expf(-lm)) * LOG2E;
        float h = 0.f;
        for (int p = 0; p < CTX + SEQ; ++p) {
            int L, t; size_t base;
            if (p < CTX) { L = CTX; base = (size_t)ML + b * CTX; t = d == 0 ? p : CTX - 1 - p; }
            else { L = SEQ; base = (size_t)b * SEQ; t = d == 0 ? (p - CTX) : (SEQ - 1 - (p - CTX)); }
            float xc = cb;
            if (t - 2 >= 0) xc += cw0 * bf2f(XR[(base + t - 2) * D + ch]);
            if (t - 1 >= 0) xc += cw1 * bf2f(XR[(base + t - 1) * D + ch]);
            xc += cw2 * bf2f(XR[(base + t) * D + ch]);
            if (t + 1 < L) xc += cw3 * bf2f(XR[(base + t + 1) * D + ch]);
            xc = bfround(xc);
            xcs[c] = xc;
            __syncthreads();
            float gr = br, gi = bi;
#pragma unroll 8
            for (int i = 0; i < 64; ++i) { const float xv = xcs[i]; gr += xv * w[0][i][c]; gi += xv * w[1][i][c]; }
            __syncthreads();
            const float rr = sigmoid_f(gr), ii = sigmoid_f(gi);
            const float a = __builtin_amdgcn_exp2f(-sp8 * rr);
            const float bb = sqrtf(fmaxf(1.0f - a * a, 0.f)) * (ii * xc);
            h = a * h + bb;
            if (p >= CTX) { const size_t idx = (base + t) * D + ch;
                if (d == 0) PART[idx] = (bf16)f2bf(h);
                else HG[idx] = (bf16)f2bf((bf2f(PART[idx]) + h) * bf2f(HG[idx])); }
        }
    }
}

__global__ void __launch_bounds__(256) naive_row1(const float* Y, const float* x, const float* mod, const float* g_norm, float* out, bf16* U2) {
    const int lane = threadIdx.x & 63, m = blockIdx.x * 4 + (threadIdx.x >> 6), r = m >> 11;
    const f32x4* yr = (const f32x4*)(Y + (size_t)m * D) + lane; const f32x4* xr = (const f32x4*)(x + (size_t)m * D) + lane;
    f32x4 y[4], x1[4]; float ss = 0.f;
#pragma unroll
    for (int j = 0; j < 4; ++j) { y[j] = yr[64 * j]; ss += (y[j].x * y[j].x + y[j].y * y[j].y) + (y[j].z * y[j].z + y[j].w * y[j].w); }
    const float rstd = 1.0f / sqrtf(wave_sum(ss) * (1.0f / D) + EPS);
    float s2 = 0.f;
#pragma unroll
    for (int j = 0; j < 4; ++j) { const int col = 4 * lane + 256 * j;
        const f32x4 g1 = *(const f32x4*)(g_norm + D + col), gt1 = *(const f32x4*)(mod + r * NMOD + 2 * D + col);
        x1[j] = xr[64 * j] + gt1 * (y[j] * rstd * g1);
        *((f32x4*)(out + (size_t)m * D) + lane + 64 * j) = x1[j];
        s2 += (x1[j].x * x1[j].x + x1[j].y * x1[j].y) + (x1[j].z * x1[j].z + x1[j].w * x1[j].w); }
    const float rstd2 = 1.0f / sqrtf(wave_sum(s2) * (1.0f / D) + EPS);
    unsigned long long* o8 = (unsigned long long*)(U2 + (size_t)m * D) + lane;
#pragma unroll
    for (int j = 0; j < 4; ++j) { const int col = 4 * lane + 256 * j;
        const f32x4 g2 = *(const f32x4*)(g_norm + 2 * D + col), sh = *(const f32x4*)(mod + r * NMOD + 3 * D + col), sc = *(const f32x4*)(mod + r * NMOD + 4 * D + col);
        const f32x4 o = (x1[j] * rstd2) * g2 * (sc + 1.0f) + sh;
        o8[64 * j] = (unsigned long long)pk2(o.x, o.y) | ((unsigned long long)pk2(o.z, o.w) << 32); }
}
__global__ void __launch_bounds__(256) naive_row2(const float* Y, const float* mod, const float* g_norm, float* out) {
    const int lane = threadIdx.x & 63, m = blockIdx.x * 4 + (threadIdx.x >> 6), r = m >> 11;
    const f32x4* yr = (const f32x4*)(Y + (size_t)m * D) + lane; f32x4* orow = (f32x4*)(out + (size_t)m * D) + lane;
    f32x4 y[4]; float ss = 0.f;
#pragma unroll
    for (int j = 0; j < 4; ++j) { y[j] = yr[64 * j]; ss += (y[j].x * y[j].x + y[j].y * y[j].y) + (y[j].z * y[j].z + y[j].w * y[j].w); }
    const float rstd = 1.0f / sqrtf(wave_sum(ss) * (1.0f / D) + EPS);
#pragma unroll
    for (int j = 0; j < 4; ++j) { const int col = 4 * lane + 256 * j;
        const f32x4 g3 = *(const f32x4*)(g_norm + 3 * D + col), gt2 = *(const f32x4*)(mod + r * NMOD + 5 * D + col);
        orow[64 * j] = orow[64 * j] + gt2 * (y[j] * rstd * g3); }
}

constexpr int LDS_BYTES = 147456;
extern "C" void kernel_launch(void* const* d_in, const int* in_sizes, int n_in, void* d_out, int out_size, void* d_ws, size_t ws_size, hipStream_t stream) {
    static int grid = 0;
    if (grid == 0) {
        if (n_in != 20 || in_sizes[0] != ML * D || out_size != ML * D || ws_size < WS_END) { fprintf(stderr, "kernel_launch: unexpected shapes (n_in %d, in0 %d, out %d, ws %zu)\n", n_in, n_in > 0 ? in_sizes[0] : -1, out_size, ws_size); grid = -1; return; }
        int dev = 0, cus = 0;
        if (hipGetDevice(&dev) != hipSuccess || hipDeviceGetAttribute(&cus, hipDeviceAttributeMultiprocessorCount, dev) != hipSuccess) { grid = -1; return; }
        if (hipFuncSetAttribute((const void*)fwd_kernel, hipFuncAttributeMaxDynamicSharedMemorySize, LDS_BYTES) != hipSuccess) { fprintf(stderr, "kernel_launch: hipFuncSetAttribute failed\n"); grid = -1; return; }
        grid = cus;
    }
    if (grid < 0) return;
    Args a{};
    const float** pp = (const float**)&a.p;
    for (int i = 0; i < 20; ++i) pp[i] = (const float*)d_in[i];
    a.p.out = (float*)d_out; a.p.ws = (unsigned char*)d_ws;
    unsigned char* ws = (unsigned char*)d_ws;
    bf16 *Win = (bf16*)(ws + WS_WIN), *Wln = (bf16*)(ws + WS_WLN), *Wo = (bf16*)(ws + WS_WO), *W1 = (bf16*)(ws + WS_W1), *W2 = (bf16*)(ws + WS_W2), *Wrg = (bf16*)(ws + WS_WRG);
    bf16 *U = (bf16*)(ws + WS_U), *XR = (bf16*)(ws + WS_XR), *HG = (bf16*)(ws + WS_HG), *AO = (bf16*)(ws + WS_AO), *KB = (bf16*)(ws + WS_K), *VB = (bf16*)(ws + WS_V), *HM = (bf16*)(ws + WS_HMID);
    bf16* GATE = (bf16*)d_out; float* mod = (float*)(ws + WS_MOD);
    a.ph_lo = 0; a.ph_hi = 1; hipLaunchKernelGGL(fwd_kernel, dim3(grid), dim3(512), LDS_BYTES, stream, a);
    a.ph_lo = 1; a.ph_hi = 2; hipLaunchKernelGGL(fwd_kernel, dim3(grid), dim3(512), LDS_BYTES, stream, a);
    naive_gemm<E1><<<dim3(DIN / 64, MT / 64), 256, 0, stream>>>(U, Win, MT, DIN, D, E1{XR, HG, AO, KB, VB, GATE, a.p.b_gate});
    naive_lru<<<dim3(BATCH * 16), 64, 0, stream>>>(XR, Wrg, U  , HG, a.p.conv_w, a.p.conv_b, a.p.b_rg, a.p.lam);
    naive_attn<<<dim3(BATCH * NH * SEQ / 64), 64, 0, stream>>>(AO, KB, VB, AO, a.p.rpb);
    float* Y = (float*)(ws + WS_K);
    naive_gemm<E2a><<<dim3(D / 64, ML / 64), 256, 0, stream>>>(HG, Wln, ML, D, D, E2a{Y});
    bf16* Z = (bf16*)(ws + WS_U);
    naive_gemm<E2b><<<dim3(D / 64, ML / 64), 256, 0, stream>>>(AO, Wln + (size_t)D * D, ML, D, D, E2b{Y, GATE, Z});
    float* Y1 = (float*)(ws + WS_HG);
    naive_gemm<E2a><<<dim3(D / 64, ML / 64), 256, 0, stream>>>(Z, Wo, ML, D, D, E2a{Y1});
    bf16* U2 = (bf16*)(ws + WS_XR);
    naive_row1<<<dim3(ML / 4), 256, 0, stream>>>(Y1, a.p.x, mod, a.p.g_norm, (float*)d_out, U2);
    naive_gemm<E4><<<dim3(FF / 64, ML / 64), 256, 0, stream>>>(U2, W1, ML, FF, D, E4{HM});
    float* Y2 = (float*)(ws + WS_U);
    naive_gemm<E2a><<<dim3(D / 64, ML / 64), 256, 0, stream>>>(HM, W2, ML, D, FF, E2a{Y2});
    naive_row2<<<dim3(ML / 4), 256, 0, stream>>>(Y2, mod, a.p.g_norm, (float*)d_out);
}
```
